# Optimizing an MI355X kernel written in HIP

```python
import math
import jax
import jax.numpy as jnp
from jax import lax
import numpy as np

D_MODEL = 1024
BATCH = 8
SEQ = 2048
DEPTH = 2
DEC_BATCH = 8
DEC_SEQ = 16
PAST_LEN = 2048

CHUNK = 64
N_A = DEPTH // 2
N_B = DEPTH - N_A
HGRN_EXPAND = 128
A_WIDTH = D_MODEL
A_HEADS = A_WIDTH // HGRN_EXPAND
A_DK = HGRN_EXPAND
A_DV = A_WIDTH // A_HEADS
B_HEADS = 16
Q_LORA = 512
KV_LORA = 256
NOPE_DIM = 128
ROPE_DIM = 64
B_DV = 128
B_WIDTH = B_HEADS * B_DV
Q_BLOCK = 128
ROPE_BASE = 10000.0
EPS = 1e-6
NEG_INF = -1e30
ATTN_SCALE = (NOPE_DIM + ROPE_DIM) ** -0.5
ALPHA = (2 * DEPTH) ** 0.25
BETA = (8 * DEPTH) ** -0.25

kernel_name = 'hybrid_hgrn2_mla_yoco_stream_step'


def rms_norm(x, g):
    xf = x.astype(jnp.float32)
    y = xf * lax.rsqrt(jnp.mean(xf * xf, axis=-1, keepdims=True) + EPS)
    return (y * g.astype(jnp.float32)).astype(x.dtype)


def layer_norm(x, g, b):
    xf = x.astype(jnp.float32)
    mu = jnp.mean(xf, axis=-1, keepdims=True)
    var = jnp.mean(jnp.square(xf - mu), axis=-1, keepdims=True)
    y = (xf - mu) * lax.rsqrt(var + EPS) * g.astype(jnp.float32) + b.astype(jnp.float32)
    return y.astype(x.dtype)


def rope(x, pos):
    half = ROPE_DIM // 2
    inv = jnp.power(ROPE_BASE, -jnp.arange(half, dtype=jnp.float32) / half)
    ang = pos.astype(jnp.float32)[:, None] * inv[None, :]
    ang = ang.reshape((ang.shape[0],) + (1,) * (x.ndim - 3) + (half,))
    cos, sin = jnp.cos(ang), jnp.sin(ang)
    xf = x.astype(jnp.float32)
    x1, x2 = xf[..., :half], xf[..., half:]
    return jnp.concatenate([x1 * cos - x2 * sin, x1 * sin + x2 * cos], axis=-1).astype(x.dtype)


def gla_chunked(q, k, v, log_f, s0, chunk):
    bsz, t, h, dk = q.shape
    dv = v.shape[-1]
    n = t // chunk
    f32 = jnp.float32
    q, k, log_f = [a.astype(f32).reshape(bsz, n, chunk, h, dk) for a in (q, k, log_f)]
    v = v.astype(f32).reshape(bsz, n, chunk, h, dv)
    b = jnp.cumsum(log_f, axis=2)
    mid = chunk // 2
    b_mid = b[:, :, mid:mid + 1]
    q_in = q * jnp.exp(b - b_mid)
    k_in = k * jnp.exp(b_mid - b)
    causal = jnp.tril(jnp.ones((chunk, chunk), dtype=bool))
    scores = jnp.einsum('bnlhk,bnshk->bnhls', q_in, k_in)
    scores = jnp.where(causal, scores, 0.0)
    o_intra = jnp.einsum('bnhls,bnshv->bnlhv', scores, v)
    b_last = b[:, :, -1]
    chunk_state = jnp.einsum('bnshk,bnshv->bnhkv', k * jnp.exp(b_last[:, :, None] - b), v)
    decay = jnp.exp(b_last)

    def step(s, inp):
        d, cs = inp
        return d[..., None] * s + cs, s

    s_final, s_prev = lax.scan(step, s0.astype(f32),
                               (jnp.moveaxis(decay, 1, 0), jnp.moveaxis(chunk_state, 1, 0)))
    s_prev = jnp.moveaxis(s_prev, 0, 1)
    o_inter = jnp.einsum('bnlhk,bnhkv->bnlhv', q * jnp.exp(b), s_prev)
    o = (o_intra + o_inter).reshape(bsz, t, h, dv)
    return o, s_final


def mixer_hgrn2(x, w_in, lb, norm_g, w_out, s0, chunk):
    bsz, t, _ = x.shape
    proj = jnp.einsum('btd,de->bte', x, w_in)
    qa, za, ia, ga = jnp.split(proj, 4, axis=-1)
    shp = (bsz, t, A_HEADS, A_DK)
    lbh = lb.reshape(A_HEADS, A_DK)
    zf = za.astype(jnp.float32).reshape(shp)
    log_f = jnp.log(lbh + (1.0 - lbh) * jax.nn.sigmoid(zf))
    k = (1.0 - lbh) * jax.nn.sigmoid(-zf)
    o, s = gla_chunked(qa.reshape(shp), k, ia.reshape(bsz, t, A_HEADS, A_DV), log_f, s0, chunk)
    o = rms_norm(o, norm_g).reshape(bsz, t, A_WIDTH).astype(x.dtype) * jax.nn.silu(ga)
    return jnp.einsum('bte,ed->btd', o, w_out), s


def shared_latent_kv(x, pos, w_dkv, kv_norm_g):
    kv = jnp.einsum('btd,de->bte', x, w_dkv)
    c = rms_norm(kv[..., :KV_LORA], kv_norm_g)
    kr = rope(kv[..., KV_LORA:], pos)
    return c, kr


def mla_queries(x, pos, w_in, q_norm_g, w_uq, w_uk):
    bsz, t, _ = x.shape
    proj = jnp.einsum('btd,de->bte', x, w_in)
    cq = rms_norm(proj[..., :Q_LORA], q_norm_g)
    gate = proj[..., Q_LORA:]
    q = jnp.einsum('btr,re->bte', cq, w_uq).reshape(bsz, t, B_HEADS, NOPE_DIM + ROPE_DIM)
    q_lat = jnp.einsum('bthn,khn->bthk', q[..., :NOPE_DIM], w_uk)
    q_rope = rope(q[..., NOPE_DIM:], pos)
    return q_lat, q_rope, gate


def latent_attend(q_lat, q_rope, c, kr, w_uv, mask):
    s = (jnp.einsum('bqhk,bsk->bhqs', q_lat, c)
         + jnp.einsum('bqhr,bsr->bhqs', q_rope, kr)).astype(jnp.float32) * ATTN_SCALE
    if mask is not None:
        s = jnp.where(mask, s, NEG_INF)
    p = jax.nn.softmax(s, axis=-1).astype(c.dtype)
    o_lat = jnp.einsum('bhqs,bsk->bqhk', p, c)
    return jnp.einsum('bqhk,khv->bqhv', o_lat, w_uv)


def attend_prompt(q_lat, q_rope, c, kr, w_uv):
    bsz, t = q_lat.shape[:2]
    nb = t // Q_BLOCK
    key_chunk = jnp.arange(t, dtype=jnp.int32) // CHUNK

    def blk(args):
        ql, qr, start = args
        q_chunk = (start + jnp.arange(Q_BLOCK, dtype=jnp.int32)) // CHUNK
        mask = key_chunk[None, :] <= q_chunk[:, None]
        return latent_attend(ql, qr, c, kr, w_uv, mask[None, None])

    to_blocks = lambda a: jnp.moveaxis(a.reshape((bsz, nb, Q_BLOCK) + a.shape[2:]), 1, 0)
    o = lax.map(blk, (to_blocks(q_lat), to_blocks(q_rope), jnp.arange(nb, dtype=jnp.int32) * Q_BLOCK))
    return jnp.moveaxis(o, 0, 1).reshape(bsz, t, B_WIDTH)


def trunk(x, pos, s0, c_past, kr_past, chunk, p):
    bsz, t, _ = x.shape
    lb_all = jnp.cumsum(jax.nn.softmax(p['lb_gamma'].astype(jnp.float32), axis=0), axis=0)
    states = []
    c_new, kr_new = None, None
    for l in range(DEPTH):
        if l < N_A:
            out, s = mixer_hgrn2(x, p['w_in_a'][l], lb_all[l], p['a_norm_g'][l], p['w_out_a'][l], s0[l], chunk)
            states.append(s)
        else:
            if l == N_A:
                c_new, kr_new = shared_latent_kv(x, pos, p['w_dkv'], p['kv_norm_g'])
            j = l - N_A
            q_lat, q_rope, gate = mla_queries(x, pos, p['w_in_b'][j], p['q_norm_g'][j], p['w_uq'][j], p['w_uk'])
            if c_past is None:
                o = attend_prompt(q_lat, q_rope, c_new, kr_new, p['w_uv'])
            else:
                c_all = jnp.concatenate([c_past.astype(c_new.dtype), c_new], axis=1)
                kr_all = jnp.concatenate([kr_past.astype(kr_new.dtype), kr_new], axis=1)
                o = latent_attend(q_lat, q_rope, c_all, kr_all, p['w_uv'], None).reshape(bsz, t, B_WIDTH)
            out = jnp.einsum('bte,ed->btd', o * jax.nn.silu(gate), p['w_out_b'][j])
        x = layer_norm(ALPHA * x + out, p['ln_g'][l], p['ln_b'][l])
    return x, jnp.stack(states), c_new, kr_new


def setup_inputs(seed: int = 0) -> dict:
    key = jax.random.key(seed)
    ks = jax.random.split(key, 20)
    nrm = lambda k, shp, s: jax.random.normal(k, shp, jnp.float32) * s
    return {
        'x_prompt': nrm(ks[0], (BATCH, SEQ, D_MODEL), 1.0),
        'x_sample': nrm(ks[1], (DEC_BATCH, DEC_SEQ, D_MODEL), 1.0),
        'state_hgrn': nrm(ks[2], (N_A, DEC_BATCH, A_HEADS, A_DK, A_DV), 0.5),
        'cache_ckv': nrm(ks[3], (DEC_BATCH, PAST_LEN, KV_LORA), 1.0),
        'cache_krope': nrm(ks[4], (DEC_BATCH, PAST_LEN, ROPE_DIM), 1.0),
        'w_in_a': nrm(ks[5], (N_A, D_MODEL, 4 * A_WIDTH), D_MODEL ** -0.5),
        'lb_gamma': nrm(ks[6], (N_A + 1, A_WIDTH), 0.1),
        'a_norm_g': 1.0 + nrm(ks[7], (N_A, A_DV), 0.02),
        'w_out_a': nrm(ks[8], (N_A, A_WIDTH, D_MODEL), BETA * A_WIDTH ** -0.5),
        'w_dkv': nrm(ks[9], (D_MODEL, KV_LORA + ROPE_DIM), D_MODEL ** -0.5),
        'kv_norm_g': 1.0 + nrm(ks[10], (KV_LORA,), 0.02),
        'w_uk': nrm(ks[11], (KV_LORA, B_HEADS, NOPE_DIM), KV_LORA ** -0.5),
        'w_uv': nrm(ks[12], (KV_LORA, B_HEADS, B_DV), KV_LORA ** -0.5),
        'w_in_b': nrm(ks[13], (N_B, D_MODEL, Q_LORA + B_WIDTH), D_MODEL ** -0.5),
        'q_norm_g': 1.0 + nrm(ks[14], (N_B, Q_LORA), 0.02),
        'w_uq': nrm(ks[15], (N_B, Q_LORA, B_HEADS * (NOPE_DIM + ROPE_DIM)), Q_LORA ** -0.5),
        'w_out_b': nrm(ks[16], (N_B, B_WIDTH, D_MODEL), BETA * B_WIDTH ** -0.5),
        'ln_g': 1.0 + nrm(ks[17], (DEPTH, D_MODEL), 0.02),
        'ln_b': nrm(ks[18], (DEPTH, D_MODEL), 0.02),
    }


def reference(x_prompt, x_sample, state_hgrn, cache_ckv, cache_krope,
              w_in_a, lb_gamma, a_norm_g, w_out_a, w_dkv, kv_norm_g, w_uk, w_uv,
              w_in_b, q_norm_g, w_uq, w_out_b, ln_g, ln_b):
    p = dict(w_in_a=w_in_a, lb_gamma=lb_gamma, a_norm_g=a_norm_g, w_out_a=w_out_a,
             w_dkv=w_dkv, kv_norm_g=kv_norm_g, w_uk=w_uk, w_uv=w_uv,
             w_in_b=w_in_b, q_norm_g=q_norm_g, w_uq=w_uq, w_out_b=w_out_b,
             ln_g=ln_g, ln_b=ln_b)
    t_p = x_prompt.shape[1]
    pos_p = jnp.arange(t_p, dtype=jnp.int32)
    s0_p = jnp.zeros((N_A, x_prompt.shape[0], A_HEADS, A_DK, A_DV), jnp.float32)
    y_prompt, state_hgrn_prompt, ckv_prompt, krope_prompt = trunk(
        x_prompt, pos_p, s0_p, None, None, CHUNK, p)
    t_s = x_sample.shape[1]
    past = cache_ckv.shape[1]
    pos_s = past + jnp.arange(t_s, dtype=jnp.int32)
    y_sample, state_hgrn_sample, ckv_sample, krope_sample = trunk(
        x_sample, pos_s, state_hgrn, cache_ckv, cache_krope, t_s, p)
    return (y_prompt, y_sample, state_hgrn_prompt, ckv_prompt, krope_prompt,
            state_hgrn_sample, ckv_sample, krope_sample)
```

```cpp
#include <hip/hip_runtime.h>
#include <cstdio>
#include <cstdint>

namespace nv {
constexpr int D = 1024, SEQ = 2048, NB = 8, DSEQ = 16, PAST = 2048;
constexpr int AH = 8, ADK = 128, BH = 16, QL = 512, KVL = 256, NOPE = 128, ROPE = 64, BDV = 128, BW = 2048;
constexpr float EPS = 1e-6f;
constexpr float ATT_SCALE = 0.07216878364870322f;
constexpr float ALPHA = 1.4142135623730951f;

__global__ void __launch_bounds__(256) gemm_generic(const float* __restrict__ A, long sam, long sak, long saz,
                                                    const float* __restrict__ B, long sbk, long sbn, long sbz,
                                                    float* __restrict__ C, long scm, long scn, long scz, int K) {
    __shared__ float As[16][65];
    __shared__ float Bs[16][65];
    const int z = blockIdx.z;
    A += z * saz; B += z * sbz; C += z * scz;
    const int m0 = blockIdx.y * 64, n0 = blockIdx.x * 64, tid = threadIdx.x;
    const int tm = (tid >> 4) * 4, tn = (tid & 15) * 4;
    float acc[4][4];
#pragma unroll
    for (int i = 0; i < 4; ++i)
#pragma unroll
        for (int j = 0; j < 4; ++j) acc[i][j] = 0.f;
    for (int k0 = 0; k0 < K; k0 += 16) {
#pragma unroll
        for (int i = 0; i < 4; ++i) {
            const int e = tid + i * 256;
            { const int kk = e & 15, mm = e >> 4; As[kk][mm] = A[(long)(m0 + mm) * sam + (long)(k0 + kk) * sak]; }
            { const int nn = e & 63, kk = e >> 6; Bs[kk][nn] = B[(long)(k0 + kk) * sbk + (long)(n0 + nn) * sbn]; }
        }
        __syncthreads();
#pragma unroll
        for (int kk = 0; kk < 16; ++kk) {
            float a[4], b[4];
#pragma unroll
            for (int i = 0; i < 4; ++i) { a[i] = As[kk][tm + i]; b[i] = Bs[kk][tn + i]; }
#pragma unroll
            for (int i = 0; i < 4; ++i)
#pragma unroll
                for (int j = 0; j < 4; ++j) acc[i][j] += a[i] * b[j];
        }
        __syncthreads();
    }
#pragma unroll
    for (int i = 0; i < 4; ++i)
#pragma unroll
        for (int j = 0; j < 4; ++j) C[(long)(m0 + tm + i) * scm + (long)(n0 + tn + j) * scn] = acc[i][j];
}

__global__ void __launch_bounds__(256) hgrn_rec(const float* __restrict__ proj, const float* __restrict__ lb_gamma, const float* __restrict__ s0,
                                                float* __restrict__ o, float* __restrict__ sfin, int T) {
    __shared__ float sq[128], sf[128], sk[128], sv[128], part[2][128];
    const int seq = blockIdx.x >> 3, h = blockIdx.x & 7, tid = threadIdx.x, vcol = tid & 127, kh = tid >> 7;
    float S[64];
#pragma unroll
    for (int j = 0; j < 64; ++j) S[j] = s0 ? s0[(((long)seq * 8 + h) * 128 + kh * 64 + j) * 128 + vcol] : 0.f;
    float lb = 0.f;
    if (tid < 128) { const float g0 = lb_gamma[h * 128 + tid], g1 = lb_gamma[1024 + h * 128 + tid]; const float mx = fmaxf(g0, g1); const float e0 = expf(g0 - mx), e1 = expf(g1 - mx); lb = e0 / (e0 + e1); }
    for (int t = 0; t < T; ++t) {
        const float* row = proj + ((long)seq * T + t) * 4096;
        if (tid < 128) {
            const float z = row[1024 + h * 128 + tid];
            const float sig = 1.f / (1.f + expf(-z));
            const float f = lb + (1.f - lb) * sig;
            sf[tid] = f; sk[tid] = (1.f - lb) * (1.f - sig); sq[tid] = row[h * 128 + tid];
        } else sv[tid - 128] = row[2048 + h * 128 + tid - 128];
        __syncthreads();
        const float v = sv[vcol]; float p = 0.f;
#pragma unroll
        for (int j = 0; j < 64; ++j) { const int k = kh * 64 + j; S[j] = sf[k] * S[j] + sk[k] * v; p += S[j] * sq[k]; }
        part[kh][vcol] = p;
        __syncthreads();
        if (kh == 0) o[((long)seq * T + t) * 1024 + h * 128 + vcol] = part[0][vcol] + part[1][vcol];
        __syncthreads();
    }
#pragma unroll
    for (int j = 0; j < 64; ++j) sfin[(((long)seq * 8 + h) * 128 + kh * 64 + j) * 128 + vcol] = S[j];
}

__device__ __forceinline__ float wsum(float v) {
#pragma unroll
    for (int o = 1; o < 64; o <<= 1) v += __shfl_xor(v, o);
    return v;
}
__device__ __forceinline__ float silu(float x) { return x / (1.f + expf(-x)); }

__global__ void __launch_bounds__(256) rms_gate(float* __restrict__ o, const float* __restrict__ proj, const float* __restrict__ g, int nrows) {
    const int w = (blockIdx.x * 256 + threadIdx.x) >> 6, lane = threadIdx.x & 63;
    if (w >= nrows * 8) return;
    const int row = w >> 3, h = w & 7;
    float* p = o + (long)row * 1024 + h * 128;
    const float a = p[lane], b = p[lane + 64];
    const float r = rsqrtf(wsum(a * a + b * b) * (1.f / 128.f) + EPS);
    const float* ga = proj + (long)row * 4096 + 3072 + h * 128;
    p[lane] = a * r * g[lane] * silu(ga[lane]);
    p[lane + 64] = b * r * g[lane + 64] * silu(ga[lane + 64]);
}
__global__ void __launch_bounds__(256) add_ln(const float* __restrict__ x, const float* __restrict__ out, const float* __restrict__ g, const float* __restrict__ b, float* __restrict__ y) {
    __shared__ float red[4];
    const long row = blockIdx.x; const int tid = threadIdx.x;
    float v[4]; float s = 0.f;
#pragma unroll
    for (int i = 0; i < 4; ++i) { const int c = tid + 256 * i; v[i] = ALPHA * x[row * 1024 + c] + out[row * 1024 + c]; s += v[i]; }
    s = wsum(s); if ((tid & 63) == 0) red[tid >> 6] = s; __syncthreads();
    const float mean = (red[0] + red[1] + red[2] + red[3]) * (1.f / 1024.f); __syncthreads();
    float q = 0.f;
#pragma unroll
    for (int i = 0; i < 4; ++i) { v[i] -= mean; q += v[i] * v[i]; }
    q = wsum(q); if ((tid & 63) == 0) red[tid >> 6] = q; __syncthreads();
    const float rstd = rsqrtf((red[0] + red[1] + red[2] + red[3]) * (1.f / 1024.f) + EPS);
#pragma unroll
    for (int i = 0; i < 4; ++i) { const int c = tid + 256 * i; y[row * 1024 + c] = v[i] * rstd * g[c] + b[c]; }
}
__global__ void __launch_bounds__(256) rmsnorm_w(const float* __restrict__ in, long ldi, float* __restrict__ out, long ldo, const float* __restrict__ g, int W, int nrows) {
    const int row = (blockIdx.x * 256 + threadIdx.x) >> 6, lane = threadIdx.x & 63;
    if (row >= nrows) return;
    float s = 0.f;
    for (int j = lane; j < W; j += 64) { const float a = in[row * ldi + j]; s += a * a; }
    const float r = rsqrtf(wsum(s) / (float)W + EPS);
    for (int j = lane; j < W; j += 64) out[row * ldo + j] = in[row * ldi + j] * r * g[j];
}
__global__ void __launch_bounds__(256) rope_k(const float* __restrict__ in, long ldi, long gsi, float* __restrict__ out, long ldo, long gso, int ngroups, int nrows, int T, int pos0) {
    const long i = (long)blockIdx.x * 256 + threadIdx.x;
    if (i >= (long)nrows * ngroups * 32) return;
    const int j = (int)(i & 31); const long rg = i >> 5; const int gi = (int)(rg % ngroups); const long row = rg / ngroups;
    const int pos = pos0 + (int)(row % T);
    const double inv = exp2(-(double)j * (13.287712379549449 / 32.0));
    const double a = (double)pos * inv; const double k = rint(a * 0.15915494309189535); const float r = (float)(a - k * 6.283185307179586);
    const float c = cosf(r), s = sinf(r);
    const float x1 = in[row * ldi + gi * gsi + j], x2 = in[row * ldi + gi * gsi + j + 32];
    out[row * ldo + gi * gso + j] = x1 * c - x2 * s;
    out[row * ldo + gi * gso + j + 32] = x1 * s + x2 * c;
}
__global__ void __launch_bounds__(256) attn_naive(const float* __restrict__ qlat, const float* __restrict__ qrope,
                                                  const float* __restrict__ cpast, const float* __restrict__ krpast, int npast,
                                                  const float* __restrict__ cnew, const float* __restrict__ krnew,
                                                  float* __restrict__ olat, int T, int causal_chunk) {
    __shared__ float sq[320];
    __shared__ float sp[2080];
    __shared__ float red[4];
    const int seq = blockIdx.y, t = blockIdx.x >> 4, h = blockIdx.x & 15, tid = threadIdx.x;
    const long qrow = (long)seq * T + t;
    sq[tid] = qlat[(qrow * 16 + h) * 256 + tid];
    if (tid < 64) sq[256 + tid] = qrope[(qrow * 16 + h) * 64 + tid];
    __syncthreads();
    const int nk = causal_chunk > 0 ? (t / causal_chunk + 1) * causal_chunk : npast + T;
    float mx = -1e30f;
    for (int s = tid; s < nk; s += 256) {
        const float* cp; const float* kp;
        if (s < npast) { cp = cpast + ((long)seq * npast + s) * 256; kp = krpast + ((long)seq * npast + s) * 64; }
        else { cp = cnew + ((long)seq * T + (s - npast)) * 256; kp = krnew + ((long)seq * T + (s - npast)) * 64; }
        float a = 0.f;
        for (int k = 0; k < 256; k += 4) { const float4 c4 = *(const float4*)(cp + k); a += sq[k] * c4.x + sq[k + 1] * c4.y + sq[k + 2] * c4.z + sq[k + 3] * c4.w; }
        for (int k = 0; k < 64; k += 4) { const float4 c4 = *(const float4*)(kp + k); a += sq[256 + k] * c4.x + sq[257 + k] * c4.y + sq[258 + k] * c4.z + sq[259 + k] * c4.w; }
        a *= ATT_SCALE; sp[s] = a; mx = fmaxf(mx, a);
    }
#pragma unroll
    for (int o = 1; o < 64; o <<= 1) mx = fmaxf(mx, __shfl_xor(mx, o));
    if ((tid & 63) == 0) red[tid >> 6] = mx; __syncthreads();
    mx = fmaxf(fmaxf(red[0], red[1]), fmaxf(red[2], red[3])); __syncthreads();
    float sum = 0.f;
    for (int s = tid; s < nk; s += 256) { const float e = expf(sp[s] - mx); sp[s] = e; sum += e; }
    sum = wsum(sum); if ((tid & 63) == 0) red[tid >> 6] = sum; __syncthreads();
    const float inv = 1.f / (red[0] + red[1] + red[2] + red[3]);
    float acc = 0.f;
    for (int s = 0; s < nk; ++s) {
        const float* cp = (s < npast) ? cpast + ((long)seq * npast + s) * 256 : cnew + ((long)seq * T + (s - npast)) * 256;
        acc += sp[s] * cp[tid];
    }
    olat[(qrow * 16 + h) * 256 + tid] = acc * inv;
}
__global__ void __launch_bounds__(256) gate_mul(float* __restrict__ o, const float* __restrict__ projB, long n) {
    const long i = (long)blockIdx.x * 256 + threadIdx.x; if (i >= n) return;
    const long row = i >> 11; const int j = (int)(i & 2047);
    o[i] *= silu(projB[row * 2560 + 512 + j]);
}

static void gemm(hipStream_t st, const float* A, long sam, long sak, long saz, const float* B, long sbk, long sbn, long sbz,
                 float* C, long scm, long scn, long scz, int M, int N, int K, int Z) {
    gemm_generic<<<dim3(N / 64, M / 64, Z), 256, 0, st>>>(A, sam, sak, saz, B, sbk, sbn, sbz, C, scm, scn, scz, K);
}
}

extern "C" void kernel_launch(void* const* d_in, const int* in_sizes, int n_in, void* d_out, int out_size, void* d_ws, size_t ws_size, hipStream_t stream) {
    using namespace nv;
    const float* x_prompt = (const float*)d_in[0]; const float* x_sample = (const float*)d_in[1]; const float* state_hgrn = (const float*)d_in[2];
    const float* cache_ckv = (const float*)d_in[3]; const float* cache_krope = (const float*)d_in[4];
    const float* w_in_a = (const float*)d_in[5]; const float* lb_gamma = (const float*)d_in[6]; const float* a_norm_g = (const float*)d_in[7];
    const float* w_out_a = (const float*)d_in[8]; const float* w_dkv = (const float*)d_in[9]; const float* kv_norm_g = (const float*)d_in[10];
    const float* w_uk = (const float*)d_in[11]; const float* w_uv = (const float*)d_in[12]; const float* w_in_b = (const float*)d_in[13];
    const float* q_norm_g = (const float*)d_in[14]; const float* w_uq = (const float*)d_in[15]; const float* w_out_b = (const float*)d_in[16];
    const float* ln_g = (const float*)d_in[17]; const float* ln_b = (const float*)d_in[18];
    float* out = (float*)d_out;
    float* y_prompt = out; float* y_sample = y_prompt + (long)NB * SEQ * D; float* st_prompt = y_sample + (long)NB * DSEQ * D;
    float* ckv_prompt = st_prompt + (long)NB * AH * 128 * 128; float* kr_prompt = ckv_prompt + (long)NB * SEQ * KVL;
    float* st_sample = kr_prompt + (long)NB * SEQ * ROPE; float* ckv_sample = st_sample + (long)NB * AH * 128 * 128; float* kr_sample = ckv_sample + (long)NB * DSEQ * KVL;
    float* ws = (float*)d_ws; long off = 0;
    auto take = [&](long n) { float* p = ws + off; off += n; return p; };
    const long R = 2048;
    float* projA = take(R * 4096); float* oa = take(R * 1024); float* outA = take(R * 1024); float* x1 = take(R * 1024);
    float* kv = take(R * 320); float* projB = take(R * 2560); float* cq = take(R * 512); float* q = take(R * 3072);
    float* qlat = take(R * 4096); float* qrope = take(R * 1024); float* olat = take(R * 4096); float* ob = take(R * 2048); float* outB = take(R * 1024);
    if ((size_t)off * 4 > ws_size) { fprintf(stderr, "ws too small\n"); return; }

    for (int pass = 0; pass < 9; ++pass) {
        const bool smp = (pass == 8);
        const int nseq = smp ? 8 : 1, T = smp ? DSEQ : SEQ, rows = nseq * T;
        const float* x = smp ? x_sample : x_prompt + (long)pass * SEQ * D;
        float* y = smp ? y_sample : y_prompt + (long)pass * SEQ * D;
        float* stf = smp ? st_sample : st_prompt + (long)pass * AH * 128 * 128;
        float* ckv = smp ? ckv_sample : ckv_prompt + (long)pass * SEQ * KVL;
        float* kr = smp ? kr_sample : kr_prompt + (long)pass * SEQ * ROPE;
        const int pos0 = smp ? PAST : 0;
        gemm(stream, x, 1024, 1, 0, w_in_a, 4096, 1, 0, projA, 4096, 1, 0, rows, 4096, 1024, 1);
        hgrn_rec<<<nseq * 8, 256, 0, stream>>>(projA, lb_gamma, smp ? state_hgrn : nullptr, oa, stf, T);
        rms_gate<<<(rows * 8 * 64 + 255) / 256, 256, 0, stream>>>(oa, projA, a_norm_g, rows);
        gemm(stream, oa, 1024, 1, 0, w_out_a, 1024, 1, 0, outA, 1024, 1, 0, rows, 1024, 1024, 1);
        add_ln<<<rows, 256, 0, stream>>>(x, outA, ln_g, ln_b, x1);
        gemm(stream, x1, 1024, 1, 0, w_dkv, 320, 1, 0, kv, 320, 1, 0, rows, 320, 1024, 1);
        rmsnorm_w<<<(rows * 64 + 255) / 256, 256, 0, stream>>>(kv, 320, ckv, 256, kv_norm_g, 256, rows);
        rope_k<<<(rows * 32 + 255) / 256, 256, 0, stream>>>(kv + 256, 320, 0, kr, 64, 0, 1, rows, T, pos0);
        gemm(stream, x1, 1024, 1, 0, w_in_b, 2560, 1, 0, projB, 2560, 1, 0, rows, 2560, 1024, 1);
        rmsnorm_w<<<(rows * 64 + 255) / 256, 256, 0, stream>>>(projB, 2560, cq, 512, q_norm_g, 512, rows);
        gemm(stream, cq, 512, 1, 0, w_uq, 3072, 1, 0, q, 3072, 1, 0, rows, 3072, 512, 1);
        gemm(stream, q, 3072, 1, 192, w_uk, 1, 2048, 128, qlat, 4096, 1, 256, rows, 256, 128, 16);
        rope_k<<<(rows * 16 * 32 + 255) / 256, 256, 0, stream>>>(q + 128, 3072, 192, qrope, 1024, 64, 16, rows, T, pos0);
        if (!smp) attn_naive<<<dim3(T * 16, 1), 256, 0, stream>>>(qlat, qrope, nullptr, nullptr, 0, ckv, kr, olat, T, 64);
        else attn_naive<<<dim3(T * 16, 8), 256, 0, stream>>>(qlat, qrope, cache_ckv, cache_krope, PAST, ckv, kr, olat, T, 0);
        gemm(stream, olat, 4096, 1, 256, w_uv, 2048, 1, 128, ob, 2048, 1, 128, rows, 128, 256, 16);
        gate_mul<<<(int)(((long)rows * 2048 + 255) / 256), 256, 0, stream>>>(ob, projB, (long)rows * 2048);
        gemm(stream, ob, 2048, 1, 0, w_out_b, 1024, 1, 0, outB, 1024, 1, 0, rows, 1024, 2048, 1);
        add_ln<<<rows, 256, 0, stream>>>(x1, outB, ln_g + 1024, ln_b + 1024, y);
    }
}
```
